# Optimizing an MI355X kernel written in HIP

```python
import math
import jax, jax.numpy as jnp
from jax import lax
import numpy as np

D_MODEL = 1024
BATCH = 16
SEQ = 2048
DEPTH = 2

HEAD_DIM = 64
A_HEADS = 6
A_PAIRS = ((128, 1), (512, 4), (2048, 16))
B_HEADS = 4
B_QK_DIM = 32
B_V_DIM = 2 * B_QK_DIM
C_HEADS = 6
C_Q_LORA = 256
C_KV_LORA = 128
C_NOPE = 64
C_ROPE = 32
C_V = 64
ROPE_THETA = 10000.0
MIX_WIDTH = (A_HEADS + B_HEADS + C_HEADS) * HEAD_DIM
A_COLS = 3 * A_HEADS * HEAD_DIM
B_COLS = B_HEADS * (2 * 2 * B_QK_DIM + B_V_DIM)
C_COLS = C_Q_LORA + C_KV_LORA + C_ROPE
IN_COLS = A_COLS + B_COLS + C_COLS
NUM_BUCKETS = 32
MAX_DISTANCE = 2048
BIAS_HEADS = A_HEADS + B_HEADS
FF_DIM = -(-8 * D_MODEL // (3 * 256)) * 256
Q_BLOCK = 128
DEEPNORM_ALPHA = (2 * DEPTH) ** 0.25
DEEPNORM_BETA = (8 * DEPTH) ** -0.25
LN_EPS = 1e-5
LATENT_EPS = 1e-6
SUBLN_EPS = 1e-5

kernel_name = "hybrid_dilated_diff_mla_deepnorm"


def layer_norm(x, g, b):
    xf = x.astype(jnp.float32)
    mu = jnp.mean(xf, axis=-1, keepdims=True)
    var = jnp.mean(jnp.square(xf - mu), axis=-1, keepdims=True)
    return ((xf - mu) * lax.rsqrt(var + LN_EPS) * g + b).astype(x.dtype)


def rms_norm(x, g, eps):
    xf = x.astype(jnp.float32)
    return (xf * lax.rsqrt(jnp.mean(xf * xf, axis=-1, keepdims=True) + eps) * g).astype(x.dtype)


def t5_bucket(dist):
    max_exact = NUM_BUCKETS // 2
    d = jnp.maximum(dist, 0)
    df = jnp.maximum(d, 1).astype(jnp.float32)
    large = max_exact + (jnp.log(df / max_exact) / math.log(MAX_DISTANCE / max_exact)
                         * (NUM_BUCKETS - max_exact)).astype(jnp.int32)
    large = jnp.minimum(large, NUM_BUCKETS - 1)
    return jnp.where(d < max_exact, d, large)


def apply_rope(x):
    S, half = x.shape[1], x.shape[-1] // 2
    inv = ROPE_THETA ** (-jnp.arange(half, dtype=jnp.float32) / half)
    ang = jnp.arange(S, dtype=jnp.float32)[:, None] * inv[None, :]
    cos, sin = jnp.cos(ang)[None, :, None, :], jnp.sin(ang)[None, :, None, :]
    xf = x.astype(jnp.float32)
    x1, x2 = xf[..., :half], xf[..., half:]
    return jnp.concatenate([x1 * cos - x2 * sin, x2 * cos + x1 * sin], axis=-1).astype(x.dtype)


def dilated_pair(q, k, v, bias_tab, window, dil):
    Bn, S, H, Dh = q.shape
    blk = window // dil
    L = S // dil
    nb = -(-L // blk)
    pad = nb * blk - L

    def to_blocks(a):
        a = a.reshape(Bn, L, dil, H, Dh)
        a = jnp.pad(a, ((0, 0), (0, pad), (0, 0), (0, 0), (0, 0)))
        return a.reshape(Bn, nb, blk, dil, H, Dh)

    def with_prev(a):
        prev = jnp.pad(a, ((0, 0), (1, 0), (0, 0), (0, 0), (0, 0), (0, 0)))[:, :nb]
        return jnp.concatenate([prev, a], axis=2)

    qb = to_blocks(q)
    kb = with_prev(to_blocks(k))
    vb = with_prev(to_blocks(v))
    rel = jnp.arange(blk)[:, None] + blk - jnp.arange(2 * blk)[None, :]
    band = (rel >= 0) & (rel <= blk)
    not_first = (jnp.arange(nb)[:, None, None] > 0) | (jnp.arange(2 * blk)[None, None, :] >= blk)
    mask = band[None] & not_first
    bias = bias_tab[t5_bucket(rel * dil)].astype(jnp.float32).transpose(2, 0, 1)
    s = jnp.einsum('bnqrhd,bnkrhd->bnrhqk', qb, kb).astype(jnp.float32) * (Dh ** -0.5) + bias
    s = jnp.where(mask[None, :, None, None], s, -jnp.inf)
    lse = jax.nn.logsumexp(s, axis=-1)
    p = jnp.exp(s - lse[..., None]).astype(v.dtype)
    o = jnp.einsum('bnrhqk,bnkrhd->bnqrhd', p, vb)
    o = o.reshape(Bn, nb * blk, dil, H, Dh)[:, :L].reshape(Bn, S, H, Dh)
    lse = lse.transpose(0, 1, 4, 2, 3).reshape(Bn, nb * blk, dil, H)[:, :L].reshape(Bn, S, H)
    return o, lse


def dilated_mixture(q, k, v, bias_tab):
    outs, lses = [], []
    for window, dil in A_PAIRS:
        o, lse = dilated_pair(q, k, v, bias_tab, window, dil)
        outs.append(o)
        lses.append(lse)
    w = jax.nn.softmax(jnp.stack(lses, axis=0), axis=0)
    o = jnp.sum(w[..., None] * jnp.stack(outs, axis=0).astype(jnp.float32), axis=0)
    return o.astype(q.dtype)


def sweep_query_blocks(block_fn, n_pos):
    o = lax.map(block_fn, jnp.arange(n_pos // Q_BLOCK))
    o = jnp.moveaxis(o, 0, 1)
    return o.reshape((o.shape[0], n_pos) + o.shape[3:])


def diff_attention(q1, q2, k1, k2, v, lam, bias_tab):
    S = q1.shape[1]
    scale = q1.shape[-1] ** -0.5
    kpos = jnp.arange(S)

    def block(i):
        start = i * Q_BLOCK
        sl = lambda a: lax.dynamic_slice_in_dim(a, start, Q_BLOCK, axis=1)
        rel = (start + jnp.arange(Q_BLOCK))[:, None] - kpos[None, :]
        causal = rel >= 0
        bias = bias_tab[t5_bucket(rel)].astype(jnp.float32).transpose(2, 0, 1)

        def probs(q, k):
            s = jnp.einsum('bqhd,bkhd->bhqk', sl(q), k).astype(jnp.float32) * scale + bias
            return jax.nn.softmax(jnp.where(causal, s, -jnp.inf), axis=-1)

        a = probs(q1, k1) - lam * probs(q2, k2)
        return jnp.einsum('bhqk,bkhd->bqhd', a.astype(v.dtype), v)

    return sweep_query_blocks(block, S)


def causal_attention(q, k, v):
    S = q.shape[1]
    scale = q.shape[-1] ** -0.5
    kpos = jnp.arange(S)

    def block(i):
        start = i * Q_BLOCK
        qs = lax.dynamic_slice_in_dim(q, start, Q_BLOCK, axis=1)
        causal = (start + jnp.arange(Q_BLOCK))[:, None] >= kpos[None, :]
        s = jnp.einsum('bqhd,bkhd->bhqk', qs, k).astype(jnp.float32) * scale
        p = jax.nn.softmax(jnp.where(causal, s, -jnp.inf), axis=-1)
        return jnp.einsum('bhqk,bkhd->bqhd', p.astype(v.dtype), v)

    return sweep_query_blocks(block, S)


def hybrid_layer(x, layer_idx, rel_bias, w_in, q_norm_g, kv_norm_g, w_uq, w_ukv,
                 diff_lambda, subln_g, w_o, ln1_g, ln1_b, ln2_g, ln2_b, w_gate, w_up, w_down):
    Bn, S, _ = x.shape
    proj = x @ w_in
    a_in, b_in, c_in = jnp.split(proj, [A_COLS, A_COLS + B_COLS], axis=-1)

    a = a_in.reshape(Bn, S, 3, A_HEADS, HEAD_DIM)
    o_a = dilated_mixture(a[:, :, 0], a[:, :, 1], a[:, :, 2], rel_bias[:, :A_HEADS])

    qk_cols = B_HEADS * 2 * B_QK_DIM
    bq = b_in[..., :qk_cols].reshape(Bn, S, B_HEADS, 2, B_QK_DIM)
    bk = b_in[..., qk_cols:2 * qk_cols].reshape(Bn, S, B_HEADS, 2, B_QK_DIM)
    bv = b_in[..., 2 * qk_cols:].reshape(Bn, S, B_HEADS, B_V_DIM)
    lam_init = 0.8 - 0.6 * math.exp(-0.3 * layer_idx)
    lf = diff_lambda.astype(jnp.float32)
    lam = jnp.exp(jnp.sum(lf[0] * lf[1])) - jnp.exp(jnp.sum(lf[2] * lf[3])) + lam_init
    o_b = diff_attention(bq[..., 0, :], bq[..., 1, :], bk[..., 0, :], bk[..., 1, :], bv, lam,
                         rel_bias[:, A_HEADS:])
    o_b = (rms_norm(o_b, subln_g, SUBLN_EPS) * (1.0 - lam_init)).astype(x.dtype)

    c_q, c_kv, k_r = jnp.split(c_in, [C_Q_LORA, C_Q_LORA + C_KV_LORA], axis=-1)
    q = (rms_norm(c_q, q_norm_g, LATENT_EPS) @ w_uq).reshape(Bn, S, C_HEADS, C_NOPE + C_ROPE)
    kv = (rms_norm(c_kv, kv_norm_g, LATENT_EPS) @ w_ukv).reshape(Bn, S, C_HEADS, C_NOPE + C_V)
    q_c = jnp.concatenate([q[..., :C_NOPE], apply_rope(q[..., C_NOPE:])], axis=-1)
    k_rope = apply_rope(k_r[:, :, None, :])
    k_c = jnp.concatenate([kv[..., :C_NOPE],
                           jnp.broadcast_to(k_rope, (Bn, S, C_HEADS, C_ROPE))], axis=-1)
    o_c = causal_attention(q_c, k_c, kv[..., C_NOPE:])

    heads = jnp.concatenate([o_a.reshape(Bn, S, -1), o_b.reshape(Bn, S, -1),
                             o_c.reshape(Bn, S, -1)], axis=-1)
    h = layer_norm(DEEPNORM_ALPHA * x + heads @ w_o, ln1_g, ln1_b)

    ffn = (jax.nn.silu(h @ w_gate) * (h @ w_up)) @ w_down
    return layer_norm(DEEPNORM_ALPHA * h + ffn, ln2_g, ln2_b)


def setup_inputs(seed: int = 0) -> dict:
    key = jax.random.key(seed)
    ks = jax.random.split(key, 20)
    f32 = jnp.float32
    nrm = lambda k, shape, scale: jax.random.normal(k, shape, f32) * scale
    return {
        "x": nrm(ks[0], (BATCH, SEQ, D_MODEL), 1.0),
        "rel_bias": nrm(ks[1], (NUM_BUCKETS, BIAS_HEADS), 0.5),
        "w_in": nrm(ks[2], (DEPTH, D_MODEL, IN_COLS), D_MODEL ** -0.5),
        "q_norm_g": 1.0 + nrm(ks[3], (DEPTH, C_Q_LORA), 0.05),
        "kv_norm_g": 1.0 + nrm(ks[4], (DEPTH, C_KV_LORA), 0.05),
        "w_uq": nrm(ks[5], (DEPTH, C_Q_LORA, C_HEADS * (C_NOPE + C_ROPE)), C_Q_LORA ** -0.5),
        "w_ukv": nrm(ks[6], (DEPTH, C_KV_LORA, C_HEADS * (C_NOPE + C_V)), C_KV_LORA ** -0.5),
        "diff_lambda": nrm(ks[7], (DEPTH, 4, B_QK_DIM), 0.1),
        "subln_g": 1.0 + nrm(ks[8], (DEPTH, B_V_DIM), 0.05),
        "w_o": nrm(ks[9], (DEPTH, MIX_WIDTH, D_MODEL), MIX_WIDTH ** -0.5 * DEEPNORM_BETA),
        "ln1_g": 1.0 + nrm(ks[10], (DEPTH, D_MODEL), 0.05),
        "ln1_b": nrm(ks[11], (DEPTH, D_MODEL), 0.02),
        "ln2_g": 1.0 + nrm(ks[12], (DEPTH, D_MODEL), 0.05),
        "ln2_b": nrm(ks[13], (DEPTH, D_MODEL), 0.02),
        "w_gate": nrm(ks[14], (DEPTH, D_MODEL, FF_DIM), D_MODEL ** -0.5),
        "w_up": nrm(ks[15], (DEPTH, D_MODEL, FF_DIM), D_MODEL ** -0.5),
        "w_down": nrm(ks[16], (DEPTH, FF_DIM, D_MODEL), FF_DIM ** -0.5 * DEEPNORM_BETA),
    }


def reference(x, rel_bias, w_in, q_norm_g, kv_norm_g, w_uq, w_ukv, diff_lambda, subln_g, w_o,
              ln1_g, ln1_b, ln2_g, ln2_b, w_gate, w_up, w_down):
    for l in range(DEPTH):
        x = hybrid_layer(x, l, rel_bias, w_in[l], q_norm_g[l], kv_norm_g[l], w_uq[l], w_ukv[l],
                         diff_lambda[l], subln_g[l], w_o[l], ln1_g[l], ln1_b[l], ln2_g[l], ln2_b[l],
                         w_gate[l], w_up[l], w_down[l])
    return x
```

```cpp
#include <hip/hip_runtime.h>
#include <cstdio>
#include <cstdint>
#include <cmath>

constexpr int BATCH = 16, SEQ = 2048, DM = 1024, M = BATCH * SEQ, DEPTH = 2;
constexpr int FF = 2816;
constexpr int IN_COLS = 2336, PW = 2560;
constexpr int A_Q = 0, A_K = 384, A_V = 768, B_Q = 1152, B_K = 1408, B_V = 1664, C_Q = 1920, C_KV = 2176, C_KR = 2304;
constexpr int QCP = 768, KVP = 768;
constexpr int H_A = 0, H_B = 384, H_C = 640;
constexpr float LOG2E = 1.4426950408889634f;
constexpr float ALPHA = 1.4142135623730951f;
constexpr float LN_EPS = 1e-5f, LATENT_EPS = 1e-6f, SUBLN_EPS = 1e-5f;
constexpr int NBD = 2052;

constexpr size_t MiB = 1u << 20;
constexpr size_t WS_CTL = 0;
constexpr size_t WS_BIASD = 1 * MiB;
constexpr size_t WS_ROPE = 1 * MiB + 128 * 1024;
constexpr size_t WS_RQ = 2 * MiB, WS_RKV = 2 * MiB + 128 * 1024;
constexpr size_t WS_XCHG = 4 * MiB;
constexpr size_t WS_W = 8 * MiB, W_LAYER = 25 * MiB;
constexpr size_t WO_IN = 0, WO_UQ = 5 * MiB, WO_UKV = 5 * MiB + 384 * 1024, WO_O = 6 * MiB, WO_GU = 8 * MiB, WO_DN = 19 * MiB;
constexpr size_t WS_XB = 58 * MiB;
constexpr size_t WS_HEADS = WS_XB;
constexpr size_t WS_PROJ = 122 * MiB;
constexpr size_t WS_QC = 282 * MiB;
constexpr size_t WS_KV = 330 * MiB;
constexpr size_t WS_ACT = 122 * MiB;
constexpr size_t WS_HB = 298 * MiB;
constexpr size_t WS_H = 378 * MiB;
constexpr size_t WS_PAO = 378 * MiB;
constexpr size_t WS_PAL = 378 * MiB + 72 * MiB;
constexpr size_t WS_END = 506 * MiB;

typedef unsigned short bf16_t;
__device__ __forceinline__ float bf2f(bf16_t v) { return __uint_as_float(((unsigned)v) << 16); }
__device__ __forceinline__ bf16_t f2bf(float f) { unsigned u = __float_as_uint(f); return (bf16_t)((u + 0x7fffu + ((u >> 16) & 1u)) >> 16); }

__device__ __forceinline__ int t5_bucket(int d) {
    if (d < 16) return d;
    const int st[16] = {16, 22, 30, 40, 54, 73, 99, 134, 182, 246, 332, 450, 609, 825, 1117, 1513};
    int b = 16;
#pragma unroll
    for (int i = 1; i < 16; ++i) b += (d >= st[i]) ? 1 : 0;
    return b;
}

__global__ void nv_tables(const float* rel_bias, float* biasd, float* rope) {
    const int i = blockIdx.x * blockDim.x + threadIdx.x;
    if (i < 10 * NBD) { const int h = i / NBD, d = i % NBD; biasd[i] = rel_bias[t5_bucket(d > 2048 ? 2048 : d) * 10 + h] * LOG2E; }
    if (i < 2048 * 16) { const int pos = i / 16, f = i % 16; const float inv = (float)pow(10000.0, -(double)f / 16.0); const float ang = (float)pos * inv;
        rope[2 * i] = (float)cos((double)ang); rope[2 * i + 1] = (float)sin((double)ang); }
}
__global__ void nv_cvt_x(const float* x, bf16_t* xb, size_t n) {
    size_t i = (size_t)blockIdx.x * blockDim.x + threadIdx.x; const size_t st = (size_t)gridDim.x * blockDim.x;
    for (; i < n; i += st) xb[i] = f2bf(x[i]);
}

template <bool DUAL, class BF, class BF2, class EPI>
__global__ void __launch_bounds__(256) nv_gemm(const bf16_t* A, long long lda_, long long K_, long long N_, BF Bf, BF2 Bf2, EPI E) {
    const int lda = (int)lda_, K = (int)K_, N = (int)N_;
    __shared__ float As[16][64 + 4], Bs[16][64 + 4], Bs2[DUAL ? 16 : 1][64 + 4];
    const int tid = threadIdx.x, tx = tid & 15, ty = tid >> 4;
    const int m0 = blockIdx.y * 64, n0 = blockIdx.x * 64;
    float acc[4][4] = {}, acc2[4][4] = {};
    for (int k0 = 0; k0 < K; k0 += 16) {
        for (int i = tid; i < 1024; i += 256) { const int kk = i & 15, r = i >> 4; As[kk][r] = bf2f(A[(size_t)(m0 + r) * lda + k0 + kk]); }
        for (int i = tid; i < 1024; i += 256) { const int c = i & 63, kk = i >> 6; const int n = n0 + c; Bs[kk][c] = (n < N) ? Bf(k0 + kk, n) : 0.f; if (DUAL) Bs2[kk][c] = (n < N) ? Bf2(k0 + kk, n) : 0.f; }
        __syncthreads();
#pragma unroll
        for (int kk = 0; kk < 16; ++kk) {
            float a[4], b[4], b2[4];
#pragma unroll
            for (int i = 0; i < 4; ++i) { a[i] = As[kk][ty * 4 + i]; b[i] = Bs[kk][tx * 4 + i]; b2[i] = DUAL ? Bs2[kk][tx * 4 + i] : 0.f; }
#pragma unroll
            for (int i = 0; i < 4; ++i)
#pragma unroll
                for (int j = 0; j < 4; ++j) { acc[i][j] += a[i] * b[j]; if (DUAL) acc2[i][j] += a[i] * b2[j]; }
        }
        __syncthreads();
    }
#pragma unroll
    for (int i = 0; i < 4; ++i)
#pragma unroll
        for (int j = 0; j < 4; ++j) { const int n = n0 + tx * 4 + j; if (n < N) E(m0 + ty * 4 + i, n, acc[i][j], acc2[i][j]); }
}
struct BfPlain { const float* W; long long N; __device__ float operator()(int k, int n) const { return bf2f(f2bf(W[(size_t)k * N + n])); } };
struct BfScaledK { const float* W; const float* g; long long N; __device__ float operator()(int k, int n) const { return bf2f(f2bf(W[(size_t)k * N + n] * g[k])); } };

struct EpiProjN { bf16_t* P; __device__ void operator()(int m, int n, float v, float) const {
    float s = 1.f; if (n < A_K) s = 0.125f * LOG2E; else if (n >= B_Q && n < B_K) s = 0.17677669529663687f * LOG2E;
    P[(size_t)m * PW + n] = f2bf(v * s); } };
__global__ void nv_zero_pad(bf16_t* P) {
    const size_t i = (size_t)blockIdx.x * blockDim.x + threadIdx.x; const int w = PW - IN_COLS;
    if (i < (size_t)M * w) P[(i / w) * PW + IN_COLS + (i % w)] = 0;
}
__global__ void nv_rope(bf16_t* buf, int pitch, int col0, int ngroups, int gstride, const float* rope) {
    const size_t idx = (size_t)blockIdx.x * blockDim.x + threadIdx.x; if (idx >= (size_t)M * ngroups * 16) return;
    const int f = idx % 16; const int g = (idx / 16) % ngroups; const int m = idx / (16 * ngroups); const int pos = m % SEQ;
    bf16_t* p = buf + (size_t)m * pitch + col0 + g * gstride;
    const float c = rope[(pos * 16 + f) * 2], s = rope[(pos * 16 + f) * 2 + 1];
    const float x1 = bf2f(p[f]), x2 = bf2f(p[f + 16]);
    p[f] = f2bf(x1 * c - x2 * s); p[f + 16] = f2bf(x2 * c + x1 * s);
}
__global__ void nv_rms(const bf16_t* P, float* rq, float* rkv) {
    const int m = blockIdx.x * blockDim.x + threadIdx.x; if (m >= M) return;
    float s = 0.f; for (int i = 0; i < 256; ++i) { const float v = bf2f(P[(size_t)m * PW + C_Q + i]); s += v * v; } rq[m] = 1.0f / sqrtf(s / 256.f + LATENT_EPS);
    s = 0.f; for (int i = 0; i < 128; ++i) { const float v = bf2f(P[(size_t)m * PW + C_KV + i]); s += v * v; } rkv[m] = 1.0f / sqrtf(s / 128.f + LATENT_EPS);
}
struct EpiRowScale { bf16_t* O; const float* r; int pitch; float cs; __device__ void operator()(int m, int n, float v, float) const { O[(size_t)m * pitch + n] = f2bf(v * r[m] * cs); } };
struct EpiResid { const float* base; float* Y; __device__ void operator()(int m, int n, float v, float) const { Y[(size_t)m * DM + n] = ALPHA * base[(size_t)m * DM + n] + v; } };
struct EpiSwiglu { bf16_t* O; __device__ void operator()(int m, int n, float g, float u) const { O[(size_t)m * FF + n] = f2bf(g / (1.f + __expf(-g)) * u); } };

__global__ void nv_ln(float* Y, bf16_t* YB, const float* g, const float* b) {
    const int row = blockIdx.x * 4 + (threadIdx.x >> 6), lane = threadIdx.x & 63; if (row >= M) return;
    float* y = Y + (size_t)row * DM; float v[16]; float s = 0.f;
    for (int i = 0; i < 16; ++i) { v[i] = y[lane + 64 * i]; s += v[i]; }
    for (int o = 32; o; o >>= 1) s += __shfl_xor(s, o);
    const float mu = s / DM; float q = 0.f;
    for (int i = 0; i < 16; ++i) { const float d = v[i] - mu; q += d * d; }
    for (int o = 32; o; o >>= 1) q += __shfl_xor(q, o);
    const float rs = 1.0f / sqrtf(q / DM + LN_EPS);
    for (int i = 0; i < 16; ++i) { const int c = lane + 64 * i; const float o = (v[i] - mu) * rs * g[c] + b[c]; y[c] = o; YB[(size_t)row * DM + c] = f2bf(o); }
}

__global__ void __launch_bounds__(64) nv_attn_a(const bf16_t* P, const float* biasd, bf16_t* HEADS) {
    const int t = blockIdx.x * 64 + threadIdx.x, h = blockIdx.y, b = blockIdx.z; const size_t row = (size_t)b * SEQ + t;
    float q[64], o[64]; for (int d = 0; d < 64; ++d) { q[d] = bf2f(P[row * PW + A_Q + h * 64 + d]); o[d] = 0.f; }
    float mx = -INFINITY, l = 0.f; const int dils[3] = {1, 4, 16};
    for (int p = 0; p < 3; ++p) { const int dil = dils[p];
        for (int j = 0; j <= 128; ++j) { const int tk = t - j * dil; if (tk < 0) break; const size_t kr = (size_t)b * SEQ + tk;
            float s = 0.f; for (int d = 0; d < 64; ++d) s += q[d] * bf2f(P[kr * PW + A_K + h * 64 + d]);
            s += biasd[h * NBD + j * dil];
            const float mn = fmaxf(mx, s), al = exp2f(mx - mn), pp = exp2f(s - mn); l = l * al + pp;
            for (int d = 0; d < 64; ++d) o[d] = o[d] * al + pp * bf2f(P[kr * PW + A_V + h * 64 + d]);
            mx = mn; } }
    for (int d = 0; d < 64; ++d) HEADS[row * DM + H_A + h * 64 + d] = f2bf(o[d] / l);
}
__global__ void __launch_bounds__(64) nv_attn_b(const bf16_t* P, const float* biasd, const float* dlam, const float* subg, double lam_init_, bf16_t* HEADS) {
    const float lam_init = (float)lam_init_;
    const int t = blockIdx.x * 64 + threadIdx.x, h = blockIdx.y, b = blockIdx.z; const size_t row = (size_t)b * SEQ + t;
    float s0 = 0.f, s1 = 0.f; for (int i = 0; i < 32; ++i) { s0 += dlam[i] * dlam[32 + i]; s1 += dlam[64 + i] * dlam[96 + i]; }
    const float lam = expf(s0) - expf(s1) + lam_init;
    float o[64]; for (int d = 0; d < 64; ++d) o[d] = 0.f;
    for (int mp = 0; mp < 2; ++mp) {
        float q[32], oo[64]; for (int d = 0; d < 32; ++d) q[d] = bf2f(P[row * PW + B_Q + h * 64 + mp * 32 + d]); for (int d = 0; d < 64; ++d) oo[d] = 0.f;
        float mx = -INFINITY, l = 0.f; const int tmax = blockIdx.x * 64 + 63;
        for (int tk = 0; tk <= tmax; ++tk) { if (tk > t) continue; const size_t kr = (size_t)b * SEQ + tk;
            float s = 0.f; for (int d = 0; d < 32; ++d) s += q[d] * bf2f(P[kr * PW + B_K + h * 64 + mp * 32 + d]);
            s += biasd[(6 + h) * NBD + (t - tk)];
            const float mn = fmaxf(mx, s), al = exp2f(mx - mn), pp = exp2f(s - mn); l = l * al + pp;
            for (int d = 0; d < 64; ++d) oo[d] = oo[d] * al + pp * bf2f(P[kr * PW + B_V + h * 64 + d]);
            mx = mn; }
        const float w = (mp == 0) ? 1.f : -lam; for (int d = 0; d < 64; ++d) o[d] += w * oo[d] / l;
    }
    float ss = 0.f; for (int d = 0; d < 64; ++d) ss += o[d] * o[d]; const float rs = 1.0f / sqrtf(ss / 64.f + SUBLN_EPS);
    for (int d = 0; d < 64; ++d) HEADS[row * DM + H_B + h * 64 + d] = f2bf(o[d] * rs * subg[d] * (1.f - lam_init));
}
__global__ void __launch_bounds__(64) nv_attn_c(const bf16_t* QC, const bf16_t* KV, const bf16_t* P, bf16_t* HEADS) {
    const int t = blockIdx.x * 64 + threadIdx.x, h = blockIdx.y, b = blockIdx.z; const size_t row = (size_t)b * SEQ + t;
    float q[96], o[64]; for (int d = 0; d < 96; ++d) q[d] = bf2f(QC[row * QCP + h * 96 + d]); for (int d = 0; d < 64; ++d) o[d] = 0.f;
    float mx = -INFINITY, l = 0.f; const int tmax = blockIdx.x * 64 + 63;
    for (int tk = 0; tk <= tmax; ++tk) { if (tk > t) continue; const size_t kr = (size_t)b * SEQ + tk;
        float s = 0.f; for (int d = 0; d < 64; ++d) s += q[d] * bf2f(KV[kr * KVP + h * 128 + d]);
        for (int d = 0; d < 32; ++d) s += q[64 + d] * bf2f(P[kr * PW + C_KR + d]);
        const float mn = fmaxf(mx, s), al = exp2f(mx - mn), pp = exp2f(s - mn); l = l * al + pp;
        for (int d = 0; d < 64; ++d) o[d] = o[d] * al + pp * bf2f(KV[kr * KVP + h * 128 + 64 + d]);
        mx = mn; }
    for (int d = 0; d < 64; ++d) HEADS[row * DM + H_C + h * 64 + d] = f2bf(o[d] / l);
}

extern "C" void kernel_launch(void* const* d_in, const int* in_sizes, int n_in, void* d_out, int out_size, void* d_ws, size_t ws_size, hipStream_t stream) {
    if (n_in != 17 || ws_size < WS_END) { fprintf(stderr, "kernel_launch: unexpected n_in %d / ws_size %zu\n", n_in, ws_size); return; }
    const float* x = (const float*)d_in[0]; const float* rel_bias = (const float*)d_in[1];
    const float* w_in = (const float*)d_in[2]; const float* qng = (const float*)d_in[3]; const float* kvng = (const float*)d_in[4];
    const float* w_uq = (const float*)d_in[5]; const float* w_ukv = (const float*)d_in[6]; const float* dlam = (const float*)d_in[7]; const float* subg = (const float*)d_in[8];
    const float* w_o = (const float*)d_in[9]; const float* ln1g = (const float*)d_in[10]; const float* ln1b = (const float*)d_in[11]; const float* ln2g = (const float*)d_in[12]; const float* ln2b = (const float*)d_in[13];
    const float* w_gate = (const float*)d_in[14]; const float* w_up = (const float*)d_in[15]; const float* w_down = (const float*)d_in[16];
    unsigned char* ws = (unsigned char*)d_ws; float* out = (float*)d_out;
    float* biasd = (float*)(ws + WS_BIASD); float* rope = (float*)(ws + WS_ROPE); float* rq = (float*)(ws + WS_RQ); float* rkv = (float*)(ws + WS_RKV);
    bf16_t* XB = (bf16_t*)(ws + WS_XB); bf16_t* HEADS = (bf16_t*)(ws + WS_HEADS); bf16_t* PROJ = (bf16_t*)(ws + WS_PROJ); bf16_t* QC = (bf16_t*)(ws + WS_QC); bf16_t* KV = (bf16_t*)(ws + WS_KV);
    bf16_t* ACT = (bf16_t*)(ws + WS_ACT); bf16_t* HB = (bf16_t*)(ws + WS_HB); float* H = (float*)(ws + WS_H);

    nv_tables<<<(2048 * 16 + 255) / 256, 256, 0, stream>>>(rel_bias, biasd, rope);
    nv_cvt_x<<<4096, 256, 0, stream>>>(x, XB, (size_t)M * DM);
    for (int l = 0; l < DEPTH; ++l) {
        const float* xres = (l == 0) ? x : out;
        const float lam_init = 0.8f - 0.6f * expf(-0.3f * (float)l);
        nv_gemm<false><<<dim3((IN_COLS + 63) / 64, M / 64), 256, 0, stream>>>(XB, DM, DM, IN_COLS, BfPlain{w_in + (size_t)l * DM * IN_COLS, IN_COLS}, BfPlain{nullptr, 0}, EpiProjN{PROJ});
        nv_zero_pad<<<((size_t)M * (PW - IN_COLS) + 255) / 256, 256, 0, stream>>>(PROJ);
        nv_rope<<<((size_t)M * 16 + 255) / 256, 256, 0, stream>>>(PROJ, PW, C_KR, 1, 0, rope);
        nv_rms<<<M / 256, 256, 0, stream>>>(PROJ, rq, rkv);
        nv_gemm<false><<<dim3(576 / 64, M / 64), 256, 0, stream>>>(PROJ + C_Q, PW, 256, 576, BfScaledK{w_uq + (size_t)l * 256 * 576, qng + l * 256, 576}, BfPlain{nullptr, 0}, EpiRowScale{QC, rq, QCP, 0.10206207261596577f * LOG2E});
        nv_rope<<<((size_t)M * 6 * 16 + 255) / 256, 256, 0, stream>>>(QC, QCP, 64, 6, 96, rope);
        nv_gemm<false><<<dim3(768 / 64, M / 64), 256, 0, stream>>>(PROJ + C_KV, PW, 128, 768, BfScaledK{w_ukv + (size_t)l * 128 * 768, kvng + l * 128, 768}, BfPlain{nullptr, 0}, EpiRowScale{KV, rkv, KVP, 1.f});
        nv_attn_a<<<dim3(SEQ / 64, 6, BATCH), 64, 0, stream>>>(PROJ, biasd, HEADS);
        nv_attn_b<<<dim3(SEQ / 64, 4, BATCH), 64, 0, stream>>>(PROJ, biasd, dlam + l * 128, subg + l * 64, (double)lam_init, HEADS);
        nv_attn_c<<<dim3(SEQ / 64, 6, BATCH), 64, 0, stream>>>(QC, KV, PROJ, HEADS);
        nv_gemm<false><<<dim3(DM / 64, M / 64), 256, 0, stream>>>(HEADS, DM, DM, DM, BfPlain{w_o + (size_t)l * DM * DM, DM}, BfPlain{nullptr, 0}, EpiResid{xres, H});
        nv_ln<<<M / 4, 256, 0, stream>>>(H, HB, ln1g + l * DM, ln1b + l * DM);
        nv_gemm<true><<<dim3(FF / 64, M / 64), 256, 0, stream>>>(HB, DM, DM, FF, BfPlain{w_gate + (size_t)l * DM * FF, FF}, BfPlain{w_up + (size_t)l * DM * FF, FF}, EpiSwiglu{ACT});
        nv_gemm<false><<<dim3(DM / 64, M / 64), 256, 0, stream>>>(ACT, FF, FF, DM, BfPlain{w_down + (size_t)l * FF * DM, DM}, BfPlain{nullptr, 0}, EpiResid{H, out});
        nv_ln<<<M / 4, 256, 0, stream>>>(out, XB, ln2g + l * DM, ln2b + l * DM);
    }
}
```
